# Optimizing an MI355X kernel written in HIP

```python
import math
import jax, jax.numpy as jnp
from jax import lax
import numpy as np

D_MODEL = 2048
BATCH = 8
SEQ = 2048
DEPTH = 4
DEC_BATCH = 4
DEC_SEQ = 2048
PAST_LEN = 128

A_HEADS = 8
A_HEAD_DIM = 64
A_WIDTH = A_HEADS * 2 * A_HEAD_DIM
B_PATTERNS = ((128, 1), (512, 4), (2048, 16))
B_GROUPS = len(B_PATTERNS)
B_HEADS = 4
B_HEAD_DIM = 128
B_WIDTH = B_GROUPS * B_HEADS * B_HEAD_DIM
B_OUT = B_HEADS * B_HEAD_DIM
GATE_WIDTH = 2 * D_MODEL
IN_WIDTH = 3 * A_WIDTH + 3 * B_WIDTH + GATE_WIDTH
IN_SPLITS = (A_WIDTH, 2 * A_WIDTH, 3 * A_WIDTH,
             3 * A_WIDTH + B_WIDTH, 3 * A_WIDTH + 2 * B_WIDTH, 3 * A_WIDTH + 3 * B_WIDTH,
             3 * A_WIDTH + 3 * B_WIDTH + D_MODEL)
D_FF = -(-8 * D_MODEL // (3 * 256)) * 256
ROPE_THETA = 500000.0
ROPE_FRAC = 4
Q_BLOCK = 128
NORM_EPS = 1e-6
MASK_VALUE = -1e30

kernel_name = "hybrid_diff_dilated_encoder"


def rms_norm(x, g):
    xf = x.astype(jnp.float32)
    y = xf * lax.rsqrt(jnp.mean(xf * xf, axis=-1, keepdims=True) + NORM_EPS)
    return (y * g.astype(jnp.float32)).astype(x.dtype)


def rope_tables(seq, rot_dim):
    inv = ROPE_THETA ** (-(jnp.arange(0, rot_dim, 2, dtype=jnp.float32) / rot_dim))
    ang = jnp.arange(seq, dtype=jnp.float32)[:, None] * inv[None, :]
    return jnp.cos(ang), jnp.sin(ang)


def apply_partial_rope(x, cos, sin):
    half = cos.shape[-1]
    rot = 2 * half
    x1 = x[..., :half].astype(jnp.float32)
    x2 = x[..., half:rot].astype(jnp.float32)
    c = cos[None, :, None, :]
    s = sin[None, :, None, :]
    rotated = jnp.concatenate([x1 * c - x2 * s, x2 * c + x1 * s], axis=-1).astype(x.dtype)
    return jnp.concatenate([rotated, x[..., rot:]], axis=-1)


def lambda_init_for(layer_idx):
    return 0.8 - 0.6 * math.exp(-0.3 * layer_idx)


def differential_attention(q, k, v, lam, subln_g, lam_init):
    bn, s_len = q.shape[0], q.shape[1]
    nblk = s_len // Q_BLOCK
    scale = A_HEAD_DIM ** -0.5
    qb = q.reshape(bn, nblk, Q_BLOCK, 2 * A_HEADS, A_HEAD_DIM).transpose(1, 0, 2, 3, 4)

    def one_block(qi):
        s = jnp.einsum('bqhd,bkhd->bhqk', qi, k, preferred_element_type=jnp.float32) * scale
        p = jax.nn.softmax(s, axis=-1).reshape(bn, A_HEADS, 2, Q_BLOCK, s_len)
        a = p[:, :, 0] - lam * p[:, :, 1]
        return jnp.einsum('bhqk,bkhe->bqhe', a.astype(v.dtype), v)

    o = lax.map(one_block, qb)
    o = o.transpose(1, 0, 2, 3, 4).reshape(bn, s_len, A_HEADS, 2 * A_HEAD_DIM)
    o = rms_norm(o, subln_g) * (1.0 - lam_init)
    return o.reshape(bn, s_len, A_WIDTH)


def dilated_attention(q, k, v, window, dilation):
    bn, s_len, nh, dh = q.shape
    half = window // (2 * dilation)
    blk = half
    n_sub = s_len // dilation
    nb = -(-n_sub // blk)
    lp = nb * blk
    bb = bn * dilation

    def to_sub(t):
        t = t.reshape(bn, n_sub, dilation, nh, dh).transpose(0, 2, 1, 3, 4)
        return t.reshape(bb, n_sub, nh, dh)

    qs, ks, vs = to_sub(q), to_sub(k), to_sub(v)
    qs = jnp.pad(qs, ((0, 0), (0, lp - n_sub), (0, 0), (0, 0))).reshape(bb, nb, blk, nh, dh)

    def windows(t):
        t = jnp.pad(t, ((0, 0), (blk, lp - n_sub + blk), (0, 0), (0, 0))).reshape(bb, nb + 2, blk, nh, dh)
        return jnp.concatenate([t[:, :-2], t[:, 1:-1], t[:, 2:]], axis=2)

    kw, vw = windows(ks), windows(vs)
    n_idx = jnp.arange(nb)[:, None, None]
    qi = n_idx * blk + jnp.arange(blk)[None, :, None]
    ki = (n_idx - 1) * blk + jnp.arange(3 * blk)[None, None, :]
    mask = (jnp.abs(ki - qi) <= half) & (ki >= 0) & (ki < n_sub)

    s = jnp.einsum('bnqhd,bnkhd->bnhqk', qs, kw, preferred_element_type=jnp.float32) * (dh ** -0.5)
    s = jnp.where(mask[None, :, None], s, MASK_VALUE)
    lse = jax.nn.logsumexp(s, axis=-1)
    p = jnp.exp(s - lse[..., None])
    o = jnp.einsum('bnhqk,bnkhd->bnqhd', p.astype(v.dtype), vw)

    o = o.reshape(bb, lp, nh, dh)[:, :n_sub]
    o = o.reshape(bn, dilation, n_sub, nh, dh).transpose(0, 2, 1, 3, 4).reshape(bn, s_len, nh, dh)
    lse = lse.transpose(0, 1, 3, 2).reshape(bb, lp, nh)[:, :n_sub]
    lse = lse.reshape(bn, dilation, n_sub, nh).transpose(0, 2, 1, 3).reshape(bn, s_len, nh)
    return o, lse


def token_mixer(xn, w_in, gate_bias, lam_p, subln_g, w_pa, w_pb, w_out, lam_init,
                cos_a, sin_a, cos_b, sin_b):
    bn, s_len, _ = xn.shape
    z = jnp.einsum('bsd,de->bse', xn, w_in)
    qa, ka, va, qb, kb, vb, ga, gb = jnp.split(z, IN_SPLITS, axis=-1)

    qa = apply_partial_rope(qa.reshape(bn, s_len, 2 * A_HEADS, A_HEAD_DIM), cos_a, sin_a)
    ka = apply_partial_rope(ka.reshape(bn, s_len, 2 * A_HEADS, A_HEAD_DIM), cos_a, sin_a)
    va = va.reshape(bn, s_len, A_HEADS, 2 * A_HEAD_DIM)
    lf = lam_p.astype(jnp.float32)
    lam = jnp.exp(jnp.sum(lf[0] * lf[1])) - jnp.exp(jnp.sum(lf[2] * lf[3])) + lam_init
    out_a = differential_attention(qa, ka, va, lam, subln_g, lam_init)

    nbh = B_GROUPS * B_HEADS
    qb = apply_partial_rope(qb.reshape(bn, s_len, nbh, B_HEAD_DIM), cos_b, sin_b)
    kb = apply_partial_rope(kb.reshape(bn, s_len, nbh, B_HEAD_DIM), cos_b, sin_b)
    qb = qb.reshape(bn, s_len, B_GROUPS, B_HEADS, B_HEAD_DIM)
    kb = kb.reshape(bn, s_len, B_GROUPS, B_HEADS, B_HEAD_DIM)
    vb = vb.reshape(bn, s_len, B_GROUPS, B_HEADS, B_HEAD_DIM)
    outs, lses = [], []
    for g, (window, dilation) in enumerate(B_PATTERNS):
        o, lse = dilated_attention(qb[:, :, g], kb[:, :, g], vb[:, :, g], window, dilation)
        outs.append(o)
        lses.append(lse)
    wts = jax.nn.softmax(jnp.stack(lses, axis=0), axis=0)
    out_b = jnp.sum(wts[..., None] * jnp.stack(outs, axis=0).astype(jnp.float32), axis=0)
    out_b = out_b.astype(xn.dtype).reshape(bn, s_len, B_OUT)

    ya = jnp.einsum('bse,ed->bsd', out_a, w_pa)
    yb = jnp.einsum('bse,ed->bsd', out_b, w_pb)
    gate_a = jax.nn.sigmoid(ga + gate_bias[0])
    gate_b = jax.nn.sigmoid(gb + gate_bias[1])
    return jnp.einsum('bsd,de->bse', gate_a * ya + gate_b * yb, w_out)


def swiglu(xn, w_ffn_in, w_ffn_out):
    h = jnp.einsum('bsd,df->bsf', xn, w_ffn_in)
    g, u = jnp.split(h, 2, axis=-1)
    return jnp.einsum('bsf,fd->bsd', jax.nn.silu(g) * u, w_ffn_out)


def encoder_trunk(x, norm_mix, norm_ffn, w_in, gate_bias, diff_lambda, diff_subln,
                  w_proj_a, w_proj_b, w_out, w_ffn_in, w_ffn_out, norm_final):
    s_len = x.shape[1]
    cos_a, sin_a = rope_tables(s_len, A_HEAD_DIM // ROPE_FRAC)
    cos_b, sin_b = rope_tables(s_len, B_HEAD_DIM // ROPE_FRAC)
    for l in range(DEPTH):
        xn = rms_norm(x, norm_mix[l])
        x = x + token_mixer(xn, w_in[l], gate_bias[l], diff_lambda[l], diff_subln[l],
                            w_proj_a[l], w_proj_b[l], w_out[l], lambda_init_for(l),
                            cos_a, sin_a, cos_b, sin_b)
        hn = rms_norm(x, norm_ffn[l])
        x = x + swiglu(hn, w_ffn_in[l], w_ffn_out[l])
    return rms_norm(x, norm_final)


def setup_inputs(seed: int = 0) -> dict:
    key = jax.random.key(seed)
    ks = jax.random.split(key, 14)

    def nrm(k, shape, scale):
        return jax.random.normal(k, shape, jnp.float32) * scale

    return {
        'x_prompt': nrm(ks[0], (BATCH, SEQ, D_MODEL), 1.0),
        'x_sample': nrm(ks[1], (DEC_BATCH, DEC_SEQ, D_MODEL), 1.0),
        'norm_mix': 1.0 + nrm(ks[2], (DEPTH, D_MODEL), 0.02),
        'norm_ffn': 1.0 + nrm(ks[3], (DEPTH, D_MODEL), 0.02),
        'w_in': nrm(ks[4], (DEPTH, D_MODEL, IN_WIDTH), D_MODEL ** -0.5),
        'gate_bias': nrm(ks[5], (DEPTH, 2, D_MODEL), 0.1),
        'diff_lambda': nrm(ks[6], (DEPTH, 4, A_HEAD_DIM), 0.1),
        'diff_subln': 1.0 + nrm(ks[7], (DEPTH, 2 * A_HEAD_DIM), 0.02),
        'w_proj_a': nrm(ks[8], (DEPTH, A_WIDTH, D_MODEL), A_WIDTH ** -0.5),
        'w_proj_b': nrm(ks[9], (DEPTH, B_OUT, D_MODEL), B_OUT ** -0.5),
        'w_out': nrm(ks[10], (DEPTH, D_MODEL, D_MODEL), D_MODEL ** -0.5),
        'w_ffn_in': nrm(ks[11], (DEPTH, D_MODEL, 2 * D_FF), D_MODEL ** -0.5),
        'w_ffn_out': nrm(ks[12], (DEPTH, D_FF, D_MODEL), D_FF ** -0.5),
        'norm_final': 1.0 + nrm(ks[13], (D_MODEL,), 0.02),
    }


def reference(x_prompt, x_sample, norm_mix, norm_ffn, w_in, gate_bias, diff_lambda, diff_subln,
              w_proj_a, w_proj_b, w_out, w_ffn_in, w_ffn_out, norm_final):
    y_prompt = encoder_trunk(x_prompt, norm_mix, norm_ffn, w_in, gate_bias, diff_lambda, diff_subln,
                             w_proj_a, w_proj_b, w_out, w_ffn_in, w_ffn_out, norm_final)
    y_sample = encoder_trunk(x_sample, norm_mix, norm_ffn, w_in, gate_bias, diff_lambda, diff_subln,
                             w_proj_a, w_proj_b, w_out, w_ffn_in, w_ffn_out, norm_final)
    return (y_prompt, y_sample)
```

```cpp
#include <hip/hip_runtime.h>
#include <cstdio>
#include <cstdint>
namespace pg8 {
#define PG8_LAS __attribute__((address_space(3)))
typedef unsigned short bf16_t;
typedef short bf16x8 __attribute__((ext_vector_type(8)));
typedef float f32x4 __attribute__((ext_vector_type(4)));
typedef unsigned u32x4 __attribute__((ext_vector_type(4)));
constexpr int BM = 256, BK = 64, HALF = 128, HTB = HALF * BK * 2  , STAGE_BYTES = 8 * HTB, NXCD = 8, WGM = 8;

__host__ __device__ __forceinline__ int lds_byte(int r, int c) { const int st = (r >> 4) * 2 + (c >> 5), rr = r & 15, cc = c & 31, ob = rr * 64 + cc * 2; return st * 1024 + (ob ^ (((ob >> 9) & 1) << 5)); }
__host__ __device__ __forceinline__ void stage_rc(int b, int& R, int& C) { const int st = b / 1024, sb = b % 1024, swz = sb ^ (((sb >> 9) & 1) << 5); R = (st >> 1) * 16 + swz / 64; C = (st & 1) * 32 + (swz % 64) / 2; }
__host__ __device__ __forceinline__ int perm32(int rho) { const int n = rho >> 4, i = rho & 15; return 8 * (i >> 2) + 4 * n + (i & 3); }

struct Unit { int pm, pn; };
struct Gemm { const bf16_t* A; const bf16_t* Bt; int M, N, K; };

struct StaticOrder {
    int nM, nN, nwg, G, c;
    __host__ __device__ void init(int M, int N, int G_, int c_) { nM = M / BM; nN = N / BM; nwg = nM * nN; G = G_; c = c_; }
    __host__ __device__ bool next(int i, Unit& u) const {
        const long L = (long)i * G + c; if (L >= nwg) return false;
        int wgid = (int)L; { const int q = nwg / NXCD, r = nwg % NXCD, xcd = wgid % NXCD, off = wgid / NXCD; wgid = (xcd < r ? xcd * (q + 1) : r * (q + 1) + (xcd - r) * q) + off; }
        const int nig = WGM * nN, gid = wgid / nig, fm = gid * WGM, gsz = (nM - fm) < WGM ? (nM - fm) : WGM;
        u.pm = fm + ((wgid % nig) % gsz); u.pn = (wgid % nig) / gsz; return true;
    }
    __device__ __forceinline__ void a_ready(const Unit&) const {}
    __device__ __forceinline__ void done(const Unit&) const {}
};

__device__ __forceinline__ unsigned cvt_pk_bf16(float lo, float hi) { unsigned r; asm volatile("v_cvt_pk_bf16_f32 %0, %1, %2" : "=v"(r) : "v"(lo), "v"(hi)); return r; }
typedef float f32x2 __attribute__((ext_vector_type(2)));
template <class Epi, class Sched, bool ALIGN_EPI = false, bool SP2 = false>
__device__ __forceinline__ void gemm_phase(PG8_LAS unsigned char* lds, const Gemm g, const Sched& S, const Epi& E) {
    int tid_ = threadIdx.x; asm volatile("" : "+v"(tid_));
    const int tid = tid_, wid = __builtin_amdgcn_readfirstlane(tid >> 6), lane = tid & 63, wr = wid >> 2, wc = wid & 3, fr = lane & 15, fq = lane >> 4;
    const int K = g.K, nt = K / BK;
    unsigned voffA[2], voffB[2];
#pragma unroll
    for (int i = 0; i < 2; ++i) { int R, C; stage_rc(tid * 16 + i * 8192, R, C); const int Rb = Epi::PERM ? ((R & ~31) + perm32(R & 31)) : R;
        voffA[i] = (unsigned)(R * K + C) * 2u; voffB[i] = (unsigned)(Rb * K + C) * 2u; }
    const size_t kstep = (size_t)(BK * 2);
    const size_t hstep = (size_t)HALF * K * 2;
    const size_t tstep = 2 * hstep;
    const unsigned ldsw = (unsigned)wid * 1024u;
    const int aoff = lds_byte(wr * 64 + fr, fq * 8), boff = lds_byte(wc * 32 + fr, fq * 8);
#define PG8_SA(b, h) (((b) * 2 + (h)) * HTB)
#define PG8_SB(b, h) ((4 + (b) * 2 + (h)) * HTB)
#define PG8_STAGE(bufoff, gbase, voff) do { _Pragma("unroll") for (int _i = 0; _i < 2; ++_i) \
        __builtin_amdgcn_global_load_lds((const unsigned*)((const char*)(gbase) + (voff)[_i]), (PG8_LAS unsigned*)(lds + (bufoff) + ldsw + _i * 8192), 16, 0, 0); } while (0)
#define PG8_LDA(dst, b, h) do { _Pragma("unroll") for (int m = 0; m < 4; ++m) _Pragma("unroll") for (int k = 0; k < 2; ++k) dst[m][k] = *(const PG8_LAS bf16x8*)(lds + PG8_SA(b, h) + aoff + m * 2048 + k * 1024); } while (0)
#define PG8_LDB(dst, b, h) do { _Pragma("unroll") for (int n = 0; n < 2; ++n) _Pragma("unroll") for (int k = 0; k < 2; ++k) dst[n][k] = *(const PG8_LAS bf16x8*)(lds + PG8_SB(b, h) + boff + n * 2048 + k * 1024); } while (0)
#define PG8_MMA(ai, bj, At, Bt) do { __builtin_amdgcn_s_setprio(1); _Pragma("unroll") for (int m = 0; m < 4; ++m) _Pragma("unroll") for (int n = 0; n < 2; ++n) _Pragma("unroll") for (int k = 0; k < 2; ++k) \
        acc[ai][bj][m][n] = __builtin_amdgcn_mfma_f32_16x16x32_bf16(Bt[n][k], At[m][k], acc[ai][bj][m][n], 0, 0, 0); __builtin_amdgcn_s_setprio(0); } while (0)
#define PG8_WAIT_V(n) asm volatile("s_waitcnt vmcnt(" #n ")" ::: "memory")
#define PG8_WAIT_L(n) asm volatile("s_waitcnt lgkmcnt(" #n ")" ::: "memory")
#define PG8_BAR __builtin_amdgcn_s_barrier()
#define PG8_SCHED __builtin_amdgcn_sched_barrier(0)
    Unit cur, nxt; int ui = 0;
    if (!S.next(0, cur)) return;
    f32x4 acc[2][2][4][2];
#pragma unroll
    for (int a = 0; a < 2; ++a)
#pragma unroll
        for (int b = 0; b < 2; ++b)
#pragma unroll
            for (int m = 0; m < 4; ++m)
#pragma unroll
                for (int n = 0; n < 2; ++n) acc[a][b][m][n] = (f32x4){0.f, 0.f, 0.f, 0.f};
    bf16x8 At[4][2], B0[2][2], B1[2][2];
    const char* cA = (const char*)g.A + (size_t)cur.pm * tstep; const char* cB = (const char*)g.Bt + (size_t)cur.pn * tstep;
    S.a_ready(cur);
    if constexpr (SP2) {
        PG8_STAGE(PG8_SB(0, 0), cB, voffB); PG8_STAGE(PG8_SB(0, 1), cB + hstep, voffB); PG8_STAGE(PG8_SA(0, 0), cA, voffA); PG8_STAGE(PG8_SA(0, 1), cA + hstep, voffA);
        if (wr == 1) PG8_BAR;
        PG8_WAIT_V(2); PG8_BAR;
        PG8_STAGE(PG8_SB(1, 0), cB + kstep, voffB); PG8_STAGE(PG8_SA(1, 0), cA + kstep, voffA); PG8_STAGE(PG8_SB(1, 1), cB + hstep + kstep, voffB);
        PG8_WAIT_V(6); PG8_BAR;
    } else {
        PG8_STAGE(PG8_SB(0, 0), cB, voffB); PG8_STAGE(PG8_SA(0, 0), cA, voffA); PG8_STAGE(PG8_SB(0, 1), cB + hstep, voffB); PG8_STAGE(PG8_SA(0, 1), cA + hstep, voffA);
        if (wr == 1) PG8_BAR;
        PG8_WAIT_V(4); PG8_BAR;
        PG8_STAGE(PG8_SB(1, 0), cB + kstep, voffB); PG8_STAGE(PG8_SA(1, 0), cA + kstep, voffA); PG8_STAGE(PG8_SB(1, 1), cB + hstep + kstep, voffB);
        PG8_WAIT_V(6); PG8_BAR;
    }
    for (;;) {
        const bool has_next = S.next(ui + 1, nxt);
        const char* nA = has_next ? (const char*)g.A + (size_t)nxt.pm * tstep : cA; const char* nB = has_next ? (const char*)g.Bt + (size_t)nxt.pn * tstep : cB;
        for (int t = 0; t < nt; t += 2) {
            const bool last = (t == nt - 2);
            const char* a1 = cA + (size_t)(t + 1) * kstep;
            const char* a2 = last ? nA : cA + (size_t)(t + 2) * kstep; const char* b2 = last ? nB : cB + (size_t)(t + 2) * kstep;
            const char* a3 = a2 + kstep; const char* b3 = b2 + kstep;
            if (last && has_next) S.a_ready(nxt);
            if constexpr (SP2) {
            PG8_LDB(B0, 0, 0); PG8_LDB(B1, 0, 1); PG8_SCHED; PG8_LDA(At, 0, 0); PG8_STAGE(PG8_SA(1, 1), a1 + hstep, voffA);
            PG8_WAIT_V(8); PG8_WAIT_L(0); PG8_BAR; PG8_MMA(0, 0, At, B0); PG8_MMA(0, 1, At, B1); PG8_BAR; PG8_SCHED;
            PG8_LDA(At, 0, 1); PG8_STAGE(PG8_SB(0, 0), b2, voffB); PG8_STAGE(PG8_SB(0, 1), b2 + hstep, voffB); PG8_STAGE(PG8_SA(0, 0), a2, voffA);
            PG8_WAIT_V(8); PG8_WAIT_L(0); PG8_BAR; PG8_MMA(1, 0, At, B0); PG8_MMA(1, 1, At, B1); PG8_BAR; PG8_SCHED;
            PG8_LDB(B0, 1, 0); PG8_LDB(B1, 1, 1); PG8_SCHED; PG8_LDA(At, 1, 0); PG8_STAGE(PG8_SA(0, 1), a2 + hstep, voffA);
            PG8_WAIT_V(8); PG8_WAIT_L(0); PG8_BAR; PG8_MMA(0, 0, At, B0); PG8_MMA(0, 1, At, B1); PG8_BAR; PG8_SCHED;
            PG8_LDA(At, 1, 1); PG8_STAGE(PG8_SB(1, 0), b3, voffB); PG8_STAGE(PG8_SB(1, 1), b3 + hstep, voffB); PG8_STAGE(PG8_SA(1, 0), a3, voffA);
            PG8_WAIT_V(8); PG8_WAIT_L(0); PG8_BAR; PG8_MMA(1, 0, At, B0); PG8_MMA(1, 1, At, B1); PG8_BAR; PG8_SCHED;
            } else {
            PG8_LDB(B0, 0, 0); PG8_SCHED; PG8_LDA(At, 0, 0); PG8_STAGE(PG8_SA(1, 1), a1 + hstep, voffA);
            PG8_WAIT_L(8); PG8_BAR; PG8_WAIT_L(0); PG8_MMA(0, 0, At, B0); PG8_BAR; PG8_SCHED;
            PG8_LDB(B1, 0, 1); PG8_STAGE(PG8_SB(0, 0), b2, voffB);
            PG8_BAR; PG8_WAIT_L(0); PG8_MMA(0, 1, At, B1); PG8_BAR;
            PG8_LDA(At, 0, 1); PG8_STAGE(PG8_SA(0, 0), a2, voffA);
            PG8_BAR; PG8_WAIT_L(0); PG8_MMA(1, 0, At, B0); PG8_BAR; PG8_SCHED;
            PG8_STAGE(PG8_SB(0, 1), b2 + hstep, voffB);
            PG8_WAIT_V(6); PG8_BAR; PG8_MMA(1, 1, At, B1); PG8_BAR;
            PG8_LDB(B0, 1, 0); PG8_SCHED; PG8_LDA(At, 1, 0); PG8_STAGE(PG8_SA(0, 1), a2 + hstep, voffA);
            PG8_WAIT_L(8); PG8_BAR; PG8_WAIT_L(0); PG8_MMA(0, 0, At, B0); PG8_BAR; PG8_SCHED;
            PG8_LDB(B1, 1, 1); PG8_STAGE(PG8_SB(1, 0), b3, voffB);
            PG8_BAR; PG8_WAIT_L(0); PG8_MMA(0, 1, At, B1); PG8_BAR;
            PG8_LDA(At, 1, 1); PG8_STAGE(PG8_SA(1, 0), a3, voffA);
            PG8_BAR; PG8_WAIT_L(0); PG8_MMA(1, 0, At, B0); PG8_BAR; PG8_SCHED;
            PG8_STAGE(PG8_SB(1, 1), b3 + hstep, voffB);
            PG8_WAIT_V(6); PG8_BAR; PG8_MMA(1, 1, At, B1); PG8_BAR;
            }
        }
        if constexpr (ALIGN_EPI) { if (wr == 0) PG8_BAR; }
        if constexpr (!Epi::AFTER_DRAIN) { E(acc, cur, wr, wc, fr, fq); S.done(cur); }
        if (!has_next) break;
#pragma unroll
        for (int a = 0; a < 2; ++a)
#pragma unroll
            for (int b = 0; b < 2; ++b)
#pragma unroll
                for (int m = 0; m < 4; ++m)
#pragma unroll
                    for (int n = 0; n < 2; ++n) acc[a][b][m][n] = (f32x4){0.f, 0.f, 0.f, 0.f};
        cur = nxt; cA = nA; cB = nB; ++ui;
        if constexpr (ALIGN_EPI) { if (wr == 1) PG8_BAR; }
    }
    PG8_WAIT_V(0);
    if constexpr (!ALIGN_EPI) { if (wr == 0) PG8_BAR; }
    PG8_BAR;
    if constexpr (Epi::AFTER_DRAIN) { E.fused(acc, cur, wr, wc, fr, fq, lds, wid, lane); S.done(cur); }
#undef PG8_SA
#undef PG8_SB
#undef PG8_STAGE
#undef PG8_LDA
#undef PG8_LDB
#undef PG8_MMA
#undef PG8_WAIT_V
#undef PG8_WAIT_L
#undef PG8_BAR
#undef PG8_SCHED
}
}
namespace pg8 {
constexpr int E_INW = 11776, E_DM = 2048, E_DFF = 5632, E_ZGA = 7680, E_SEQ = 2048, E_MP = 16384;
__device__ __forceinline__ float bflo(unsigned w) { return __uint_as_float(w << 16); }
__device__ __forceinline__ float bfhi(unsigned w) { return __uint_as_float(w & 0xffff0000u); }
__device__ __forceinline__ float sigmoid_f(float v) { return __builtin_amdgcn_rcpf(1.0f + __builtin_amdgcn_exp2f(-1.4426950408889634f * v)); }
__device__ __forceinline__ u32x4 pack8(const float* v) { u32x4 w; w.x = cvt_pk_bf16(v[0], v[1]); w.y = cvt_pk_bf16(v[2], v[3]); w.z = cvt_pk_bf16(v[4], v[5]); w.w = cvt_pk_bf16(v[6], v[7]); return w; }

struct EpiIn {
    static constexpr bool PERM = true, AFTER_DRAIN = false;
    bf16_t* Z; const float* ropeA; const float* ropeB; const float* gbias;
    __device__ __forceinline__ void operator()(const f32x4 (&acc)[2][2][4][2], const Unit& u, int wr, int wc, int fr, int fq) const {
        const int pn = u.pn;
        const int row0 = u.pm * BM + wr * 64 + fr, colw = pn * BM + wc * 32 + 8 * fq;
        int mode = 0;
        if (pn < 8) mode = 1; else if (pn < 12) mode = 0; else if (pn < 24) mode = 2; else if (pn < 30) mode = 0; else mode = 3;
        const bool ropeA_w = (mode == 1) && ((wc & 1) == 0);
        const bool ropeB_w = (mode == 2) && (wc == 0);
#pragma unroll
        for (int ai = 0; ai < 2; ++ai)
#pragma unroll
            for (int m = 0; m < 4; ++m) {
                const int row = row0 + ai * HALF + m * 16; const int pos = row & (E_SEQ - 1);
                bf16_t* rowp = Z + (size_t)row * E_INW + colw;
#pragma unroll
                for (int bj = 0; bj < 2; ++bj) {
                    float v[8];
#pragma unroll
                    for (int j = 0; j < 4; ++j) { v[j] = acc[ai][bj][m][0][j]; v[4 + j] = acc[ai][bj][m][1][j]; }
                    if (ropeA_w) {
                        float p[8];
#pragma unroll
                        for (int j = 0; j < 8; ++j) p[j] = __shfl_xor(v[j], 16);
                        if (fq < 2) {
                            const f32x4* cs = (const f32x4*)(ropeA + pos * 16); const f32x4 c0 = cs[0], c1 = cs[1], s0 = cs[2], s1 = cs[3];
                            const float sg = (fq == 0) ? -1.f : 1.f;
#pragma unroll
                            for (int j = 0; j < 4; ++j) { v[j] = v[j] * c0[j] + sg * p[j] * s0[j]; v[4 + j] = v[4 + j] * c1[j] + sg * p[4 + j] * s1[j]; }
                        }
                    } else if (ropeB_w) {
                        float p[8];
#pragma unroll
                        for (int j = 0; j < 8; ++j) p[j] = __shfl_xor(v[j], 32);
                        const float* tb = ropeB + pos * 32 + 8 * (fq & 1);
                        const f32x4 c0 = *(const f32x4*)(tb), c1 = *(const f32x4*)(tb + 4), s0 = *(const f32x4*)(tb + 16), s1 = *(const f32x4*)(tb + 20);
                        const float sg = (fq < 2) ? -1.f : 1.f;
#pragma unroll
                        for (int j = 0; j < 4; ++j) { v[j] = v[j] * c0[j] + sg * p[j] * s0[j]; v[4 + j] = v[4 + j] * c1[j] + sg * p[4 + j] * s1[j]; }
                    } else if (mode == 3) {
                        const float* bp = gbias + (colw + bj * HALF - E_ZGA);
                        const f32x4 b0 = *(const f32x4*)bp, b1 = *(const f32x4*)(bp + 4);
#pragma unroll
                        for (int j = 0; j < 4; ++j) { v[j] = sigmoid_f(v[j] + b0[j]); v[4 + j] = sigmoid_f(v[4 + j] + b1[j]); }
                    }
                    *(u32x4*)(rowp + bj * HALF) = pack8(v);
                }
            }
    }
};
template <int MODE> struct EpiGate {
    static constexpr bool PERM = true, AFTER_DRAIN = false;
    bf16_t* O; const bf16_t* Z; int gcol0;
    __device__ __forceinline__ void operator()(const f32x4 (&acc)[2][2][4][2], const Unit& u, int wr, int wc, int fr, int fq) const {
        const int row0 = u.pm * BM + wr * 64 + fr, colw = u.pn * BM + wc * 32 + 8 * fq;
#pragma unroll
        for (int ai = 0; ai < 2; ++ai)
#pragma unroll
            for (int m = 0; m < 4; ++m) {
                const int row = row0 + ai * HALF + m * 16;
#pragma unroll
                for (int bj = 0; bj < 2; ++bj) {
                    const int col = colw + bj * HALF;
                    const u32x4 g = *(const u32x4*)(Z + (size_t)row * E_INW + gcol0 + col);
                    bf16_t* op = O + (size_t)row * E_DM + col;
                    float v[8];
                    v[0] = acc[ai][bj][m][0][0] * bflo(g.x); v[1] = acc[ai][bj][m][0][1] * bfhi(g.x); v[2] = acc[ai][bj][m][0][2] * bflo(g.y); v[3] = acc[ai][bj][m][0][3] * bfhi(g.y);
                    v[4] = acc[ai][bj][m][1][0] * bflo(g.z); v[5] = acc[ai][bj][m][1][1] * bfhi(g.z); v[6] = acc[ai][bj][m][1][2] * bflo(g.w); v[7] = acc[ai][bj][m][1][3] * bfhi(g.w);
                    if (MODE == 1) { const u32x4 t = *(const u32x4*)op;
                        v[0] += bflo(t.x); v[1] += bfhi(t.x); v[2] += bflo(t.y); v[3] += bfhi(t.y); v[4] += bflo(t.z); v[5] += bfhi(t.z); v[6] += bflo(t.w); v[7] += bfhi(t.w); }
                    *(u32x4*)op = pack8(v);
                }
            }
    }
};
struct EpiResid {
    static constexpr bool PERM = false, AFTER_DRAIN = false;
    const float* base_lo; const float* base_hi; float* out;
    __device__ __forceinline__ void operator()(const f32x4 (&acc)[2][2][4][2], const Unit& u, int wr, int wc, int fr, int fq) const {
        const int row0 = u.pm * BM + wr * 64 + fr, col0 = u.pn * BM + wc * 32 + 4 * fq;
        const float* bb = (u.pm < E_MP / BM) ? base_lo + (size_t)row0 * E_DM : base_hi + (size_t)(row0 - E_MP) * E_DM;
        float* ob = out + (size_t)row0 * E_DM;
#pragma unroll
        for (int ai = 0; ai < 2; ++ai)
#pragma unroll
            for (int m = 0; m < 4; ++m) { const size_t ro = (size_t)(ai * HALF + m * 16) * E_DM + col0;
#pragma unroll
                for (int bj = 0; bj < 2; ++bj)
#pragma unroll
                    for (int n = 0; n < 2; ++n) { const f32x4 b = *(const f32x4*)(bb + ro + bj * HALF + n * 16); *(f32x4*)(ob + ro + bj * HALF + n * 16) = b + acc[ai][bj][m][n]; } }
    }
};
struct EpiSwiglu {
    static constexpr bool PERM = true, AFTER_DRAIN = false;
    bf16_t* ACT;
    __device__ __forceinline__ void operator()(const f32x4 (&acc)[2][2][4][2], const Unit& u, int wr, int wc, int fr, int fq) const {
        const int row0 = u.pm * BM + wr * 64 + fr, col = u.pn * HALF + wc * 32 + 8 * fq;
#pragma unroll
        for (int ai = 0; ai < 2; ++ai)
#pragma unroll
            for (int m = 0; m < 4; ++m) {
                float v[8];
#pragma unroll
                for (int n = 0; n < 2; ++n)
#pragma unroll
                    for (int j = 0; j < 4; ++j) { const float g = acc[ai][0][m][n][j], uu = acc[ai][1][m][n][j]; v[4 * n + j] = g * sigmoid_f(g) * uu; }
                *(u32x4*)(ACT + (size_t)(row0 + ai * HALF + m * 16) * E_DFF + col) = pack8(v);
            }
    }
};
}
namespace att {
using bf16x8 = __attribute__((ext_vector_type(8))) short;
using s16x4  = __attribute__((ext_vector_type(4))) short;
using f32x16 = __attribute__((ext_vector_type(16))) float;
using u32x4  = __attribute__((ext_vector_type(4))) unsigned;
typedef unsigned short bf16;
constexpr int NW = 8, QBLK = 32, KVBLK = 64, LDZ = 11776, SEQL = 2048;
constexpr int SHM_V = KVBLK * 128 * 2, SHM_K = KVBLK * 128 * 2, SHM_ATTN = 2 * SHM_V + 2 * SHM_K + NW * 64 * 4;
constexpr float THR = 8.f;
#define ATT_KSWZ(row, colB) ((row) * 256 + ((colB) ^ (((row) & 7) << 4)))
#define ATT_SBAR() __builtin_amdgcn_sched_barrier(0)
__device__ __forceinline__ int crow(int r, int hi) { return (r & 3) + 8 * (r >> 2) + 4 * hi; }
__device__ __forceinline__ unsigned cvtpk(float lo, float hi) { unsigned r; asm volatile("v_cvt_pk_bf16_f32 %0, %1, %2" : "=v"(r) : "v"(lo), "v"(hi)); return r; }
template <int DQK> struct Sc { static constexpr float SCALE = (DQK == 64) ? 0.125f : 0.08838834764831845f; };
template <int DQK> __device__ __forceinline__ void partialSM(f32x16& p0, f32x16& p1, float& m_reg, float& mn, float& alpha) {
  constexpr float SCALE = Sc<DQK>::SCALE, C = SCALE * 1.4426950408889634f;
  float pmax = p0[0];
#pragma unroll
  for (int r = 1; r < 16; ++r) pmax = fmaxf(pmax, p0[r]);
#pragma unroll
  for (int r = 0; r < 16; ++r) pmax = fmaxf(pmax, p1[r]);
  { auto rr = __builtin_amdgcn_permlane32_swap(__float_as_uint(pmax), __float_as_uint(pmax), false, false);
    pmax = fmaxf(__uint_as_float(rr[0]), __uint_as_float(rr[1])); }
  if (__builtin_expect(__all(pmax - m_reg <= THR / SCALE), 1)) { mn = m_reg; alpha = 1.f; }
  else { mn = fmaxf(m_reg, pmax); alpha = __builtin_amdgcn_exp2f((m_reg - mn) * C); m_reg = mn; }
  const float mnC = -mn * C;
#pragma unroll
  for (int r = 0; r < 16; ++r) p0[r] = fmaf(p0[r], C, mnC);
#pragma unroll
  for (int r = 0; r < 16; ++r) p1[r] = fmaf(p1[r], C, mnC);
#pragma unroll
  for (int r = 0; r < 16; ++r) p0[r] = __builtin_amdgcn_exp2f(p0[r]);
}
__device__ __forceinline__ void finishSM(f32x16& p0, f32x16& p1, float alpha, float& l_reg, bf16x8& pa0, bf16x8& pa1, bf16x8& pa2, bf16x8& pa3) {
#pragma unroll
  for (int r = 0; r < 16; ++r) p1[r] = __builtin_amdgcn_exp2f(p1[r]);
  float ps = 0;
#pragma unroll
  for (int r = 0; r < 16; ++r) ps += p0[r];
#pragma unroll
  for (int r = 0; r < 16; ++r) ps += p1[r];
  { auto rr = __builtin_amdgcn_permlane32_swap(__float_as_uint(ps), __float_as_uint(ps), false, false);
    ps = __uint_as_float(rr[0]) + __uint_as_float(rr[1]); }
  l_reg = l_reg * alpha + ps;
#define ATT_PK4(P, BASE, OUT) do { unsigned a0 = cvtpk(P[BASE + 0], P[BASE + 1]), a1 = cvtpk(P[BASE + 2], P[BASE + 3]);   \
    unsigned b0 = cvtpk(P[BASE + 4], P[BASE + 5]), b1 = cvtpk(P[BASE + 6], P[BASE + 7]);                              \
    auto r0 = __builtin_amdgcn_permlane32_swap(a0, b0, false, false); auto r1 = __builtin_amdgcn_permlane32_swap(a1, b1, false, false); \
    u32x4 w = {r0[0], r1[0], r0[1], r1[1]}; OUT = *reinterpret_cast<bf16x8*>(&w); } while (0)
  ATT_PK4(p0, 0, pa0); ATT_PK4(p0, 8, pa1); ATT_PK4(p1, 0, pa2); ATT_PK4(p1, 8, pa3);
#undef ATT_PK4
}
template <int ND0> __device__ __forceinline__ void qkt(f32x16& p0, f32x16& p1, const char* Ks, const bf16x8* qr, int r32, int hi, int d0b) {
  p0 = f32x16{}; p1 = f32x16{};
#pragma unroll
  for (int d0 = 0; d0 < ND0; ++d0) { const int cb = ((d0b + d0) * 16 + hi * 8) * 2;
    const bf16x8 b0 = *reinterpret_cast<const bf16x8*>(Ks + ATT_KSWZ(r32, cb));
    const bf16x8 b1 = *reinterpret_cast<const bf16x8*>(Ks + ATT_KSWZ(32 + r32, cb));
    p0 = __builtin_amdgcn_mfma_f32_32x32x16_bf16(b0, qr[d0], p0, 0, 0, 0);
    p1 = __builtin_amdgcn_mfma_f32_32x32x16_bf16(b1, qr[d0], p1, 0, 0, 0); }
}
__device__ __forceinline__ int v_st(int k, int c) { const int kk = (k & ~0xC) | ((k & 4) << 1) | ((k & 8) >> 1); return ((kk >> 3) * 4 + (c >> 5)) * 512 + ((kk & 7) * 32 + (c & 31)) * 2; }
__device__ __forceinline__ int v_rd_base(int lane) { return ((lane & 3) << 3) | (((lane >> 2) & 3) << 6) | (((lane >> 4) & 1) << 5) | (((lane >> 5) & 1) << 8); }
constexpr int v_rd_off(int d0, int ks, int half) { return d0 * 512 + ks * 4096 + half * 2048; }
template <int OFF> __device__ __forceinline__ s16x4 tr_read(int vb) { s16x4 r; asm volatile("ds_read_b64_tr_b16 %0, %1 offset:%2" : "=&v"(r) : "v"(vb), "i"(OFF) : "memory"); return r; }
template <int D0> __device__ __forceinline__ void pv_one(f32x16& od, int vb, bf16x8 pa0, bf16x8 pa1, bf16x8 pa2, bf16x8 pa3) {
  const s16x4 l0 = tr_read<v_rd_off(D0, 0, 0)>(vb), h0 = tr_read<v_rd_off(D0, 0, 1)>(vb), l1 = tr_read<v_rd_off(D0, 1, 0)>(vb), h1 = tr_read<v_rd_off(D0, 1, 1)>(vb);
  const s16x4 l2 = tr_read<v_rd_off(D0, 2, 0)>(vb), h2 = tr_read<v_rd_off(D0, 2, 1)>(vb), l3 = tr_read<v_rd_off(D0, 3, 0)>(vb), h3 = tr_read<v_rd_off(D0, 3, 1)>(vb);
  asm volatile("s_waitcnt lgkmcnt(0)" ::: "memory"); ATT_SBAR();
#define ATT_PK(L, H) (bf16x8){L[0], L[1], L[2], L[3], H[0], H[1], H[2], H[3]}
  od = __builtin_amdgcn_mfma_f32_32x32x16_bf16(pa0, ATT_PK(l0, h0), od, 0, 0, 0);
  od = __builtin_amdgcn_mfma_f32_32x32x16_bf16(pa1, ATT_PK(l1, h1), od, 0, 0, 0);
  od = __builtin_amdgcn_mfma_f32_32x32x16_bf16(pa2, ATT_PK(l2, h2), od, 0, 0, 0);
  od = __builtin_amdgcn_mfma_f32_32x32x16_bf16(pa3, ATT_PK(l3, h3), od, 0, 0, 0);
#undef ATT_PK
}
__device__ __forceinline__ void pv_d0(f32x16* o, int vb, bf16x8 pa0, bf16x8 pa1, bf16x8 pa2, bf16x8 pa3) {
  pv_one<0>(o[0], vb, pa0, pa1, pa2, pa3); pv_one<1>(o[1], vb, pa0, pa1, pa2, pa3); pv_one<2>(o[2], vb, pa0, pa1, pa2, pa3); pv_one<3>(o[3], vb, pa0, pa1, pa2, pa3);
}
__device__ __forceinline__ float bflo(unsigned w) { return __uint_as_float(w << 16); }

struct UnitP {
  const bf16* Zb;
  int qcol, kcol, vcol;
  int q0;
  int ts, nt;
  int ldil, lnsub;
};
template <bool DIL> __device__ __forceinline__ int tokrow(int v, int ldil, int lnsub) { return DIL ? (((v & ((1 << lnsub) - 1)) << ldil) + (v >> lnsub)) : v; }

struct EpiDiff { bf16* outa; const float* subln; float lam, osc; int h; long rowbase; };
struct EpiDil  { bf16* obp; float* lse; int hh; long rowbase; };

template <bool DIL, class EP>
__device__ __forceinline__ void attn_unit(const UnitP U, const EP E, char* lds) {
  constexpr int DQK = DIL ? 128 : 64, ND0 = DQK / 16;
  constexpr float SCALE = Sc<DQK>::SCALE;
  int tid_ = threadIdx.x; asm volatile("" : "+v"(tid_));
  const int tid = tid_, wid = tid >> 6, lane = tid & 63, r32 = lane & 31, hi = lane >> 5;
  char* V_lds = lds; char* K_lds = lds + 2 * SHM_V;
  float* ws = (float*)(lds + 2 * SHM_V + 2 * SHM_K) + wid * 64; float* li_l = ws; float* al_l = ws + 32;
  float m_reg = -1e30f, l_reg = 0; f32x16 o[4] = {}; bf16x8 qr[ND0];
  const int qrow_w = DIL ? wid * QBLK : (wid & 3) * QBLK;
  const int d0b = DIL ? 0 : 4 * (wid >> 2);
  { const int vq = U.q0 + qrow_w + r32; const bf16* Qw = U.Zb + (long)tokrow<DIL>(vq, U.ldil, U.lnsub) * LDZ + U.qcol + (DIL ? 0 : (wid >> 2) * 64) + hi * 8;
#pragma unroll
    for (int d0 = 0; d0 < ND0; ++d0) qr[d0] = *reinterpret_cast<const bf16x8*>(Qw + d0 * 16); }
  const int sr = tid >> 4, sc = (tid & 15) * 8, vst0 = v_st(sr, sc), vst1 = v_st(32 + sr, sc);
  const int vb0 = (int)(uintptr_t)V_lds + v_rd_base(lane);
  bf16x8 sv0[2], sv1[2], sk0[2], sk1[2];
#define ATT_SLOAD(i, t) do { const int v0_ = (U.ts + (t)) * KVBLK + sr; const long ra_ = (long)tokrow<DIL>(v0_, U.ldil, U.lnsub) * LDZ, rb_ = (long)tokrow<DIL>(v0_ + 32, U.ldil, U.lnsub) * LDZ; \
    sv0[i] = *reinterpret_cast<const bf16x8*>(U.Zb + ra_ + U.vcol + sc); sv1[i] = *reinterpret_cast<const bf16x8*>(U.Zb + rb_ + U.vcol + sc); \
    sk0[i] = *reinterpret_cast<const bf16x8*>(U.Zb + ra_ + U.kcol + sc); sk1[i] = *reinterpret_cast<const bf16x8*>(U.Zb + rb_ + U.kcol + sc); } while (0)
#define ATT_SWRITE(b, i) do { *(bf16x8*)(V_lds + (b) * SHM_V + vst0) = sv0[i]; *(bf16x8*)(V_lds + (b) * SHM_V + vst1) = sv1[i]; const int kc_ = sc * 2; \
    *(bf16x8*)(K_lds + (b) * SHM_K + ATT_KSWZ(sr, kc_)) = sk0[i]; *(bf16x8*)(K_lds + (b) * SHM_K + ATT_KSWZ(32 + sr, kc_)) = sk1[i]; } while (0)
#define ATT_SWAIT() asm volatile("s_waitcnt vmcnt(4)" ::: "memory")
#define ATT_RESC(a) do { if (__any((a) < 1.f)) { if (hi == 0) al_l[r32] = (a); asm volatile("s_waitcnt lgkmcnt(0)" ::: "memory"); \
    _Pragma("unroll") for (int d = 0; d < 4; ++d) _Pragma("unroll") for (int r = 0; r < 16; ++r) o[d][r] *= al_l[crow(r, hi)]; } } while (0)
  const int vq = U.q0 + qrow_w + r32;
#define ATT_MASK(P0, P1, t) do { if (DIL) { const int kb_ = (U.ts + (t)) * KVBLK + 4 * hi; \
    _Pragma("unroll") for (int r = 0; r < 16; ++r) { const int k0_ = kb_ + (r & 3) + 8 * (r >> 2), k1_ = k0_ + 32; \
      const int d0_ = k0_ - vq, d1_ = k1_ - vq; \
      const bool ok0_ = (d0_ <= 64) && (d0_ >= -64) && (((k0_ ^ vq) >> U.lnsub) == 0), ok1_ = (d1_ <= 64) && (d1_ >= -64) && (((k1_ ^ vq) >> U.lnsub) == 0); \
      P0[r] = ok0_ ? P0[r] : -30000.f; P1[r] = ok1_ ? P1[r] : -30000.f; } } } while (0)
  f32x16 pA0, pA1, pB0, pB1; float mnA, mnB, alA, alB; bf16x8 pa0, pa1, pa2, pa3; const int NT = U.nt;
  ATT_SLOAD(0, 0); asm volatile("s_waitcnt vmcnt(0)" ::: "memory"); ATT_SWRITE(0, 0); __syncthreads();
  qkt<ND0>(pA0, pA1, K_lds, qr, r32, hi, d0b); ATT_MASK(pA0, pA1, 0); partialSM<DQK>(pA0, pA1, m_reg, mnA, alA);
  ATT_SLOAD(1, 1); if (2 < NT) ATT_SLOAD(0, 2);
  ATT_SWAIT(); ATT_SWRITE(1, 1); __syncthreads();
  for (int j = 1; j + 1 < NT; j += 2) {
    ATT_SBAR(); qkt<ND0>(pB0, pB1, K_lds + SHM_K, qr, r32, hi, d0b);
    finishSM(pA0, pA1, alA, l_reg, pa0, pa1, pa2, pa3); ATT_SBAR();
    ATT_SLOAD(1, j + 2); ATT_SBAR();
    pv_d0(o, vb0, pa0, pa1, pa2, pa3); ATT_MASK(pB0, pB1, j); partialSM<DQK>(pB0, pB1, m_reg, mnB, alB);
    __syncthreads(); ATT_SWAIT(); ATT_SWRITE(0, 0);
    ATT_RESC(alB); __syncthreads();
    ATT_SBAR(); qkt<ND0>(pA0, pA1, K_lds, qr, r32, hi, d0b);
    finishSM(pB0, pB1, alB, l_reg, pa0, pa1, pa2, pa3); ATT_SBAR();
    if (j + 3 < NT) ATT_SLOAD(0, j + 3); ATT_SBAR();
    pv_d0(o, vb0 + SHM_V, pa0, pa1, pa2, pa3); ATT_MASK(pA0, pA1, j + 1); partialSM<DQK>(pA0, pA1, m_reg, mnA, alA);
    __syncthreads(); ATT_SWAIT(); ATT_SWRITE(1, 1);
    ATT_RESC(alA); __syncthreads();
  }
  ATT_SBAR(); qkt<ND0>(pB0, pB1, K_lds + SHM_K, qr, r32, hi, d0b);
  finishSM(pA0, pA1, alA, l_reg, pa0, pa1, pa2, pa3); ATT_SBAR();
  pv_d0(o, vb0, pa0, pa1, pa2, pa3); ATT_MASK(pB0, pB1, NT - 1); partialSM<DQK>(pB0, pB1, m_reg, mnB, alB);
  __syncthreads(); ATT_RESC(alB);
  finishSM(pB0, pB1, alB, l_reg, pa0, pa1, pa2, pa3); ATT_SBAR();
  pv_d0(o, vb0 + SHM_V, pa0, pa1, pa2, pa3);
  if (hi == 0) li_l[r32] = l_reg; asm volatile("s_waitcnt lgkmcnt(0)" ::: "memory");
  float rli[16];
#pragma unroll
  for (int r = 0; r < 16; ++r) rli[r] = __builtin_amdgcn_rcpf(li_l[crow(r, hi)]);
  if constexpr (DIL) {
#pragma unroll
    for (int r = 0; r < 16; ++r) { const int vrow = U.q0 + qrow_w + crow(r, hi); bf16* op = E.obp + (E.rowbase + tokrow<true>(vrow, U.ldil, U.lnsub)) * 512 + E.hh * 128 + r32;
#pragma unroll
      for (int d0 = 0; d0 < 4; ++d0) op[d0 * 32] = (bf16)(cvtpk(o[d0][r] * rli[r], 0.f) & 0xffffu); }
    if (hi == 0) E.lse[(E.rowbase + tokrow<true>(vq, U.ldil, U.lnsub)) * 4 + E.hh] = SCALE * m_reg + logf(l_reg);
    __syncthreads();
  } else {
    float* ex = (float*)lds + (wid & 3) * 4096;
    __syncthreads();
    if (wid >= 4) {
#pragma unroll
      for (int d0 = 0; d0 < 4; ++d0)
#pragma unroll
        for (int r = 0; r < 16; ++r) ex[(d0 * 16 + r) * 64 + lane] = o[d0][r] * rli[r] * E.lam;
    }
    __syncthreads();
    if (wid < 4) {
      float ss[16];
#pragma unroll
      for (int r = 0; r < 16; ++r) { float s = 0.f;
#pragma unroll
        for (int d0 = 0; d0 < 4; ++d0) { const float d = o[d0][r] * rli[r] - ex[(d0 * 16 + r) * 64 + lane]; o[d0][r] = d; s += d * d; }
        ss[r] = s; }
#pragma unroll
      for (int off = 1; off < 32; off <<= 1)
#pragma unroll
        for (int r = 0; r < 16; ++r) ss[r] += __shfl_xor(ss[r], off);
      float gcol[4];
#pragma unroll
      for (int d0 = 0; d0 < 4; ++d0) gcol[d0] = E.subln[d0 * 32 + r32] * E.osc;
#pragma unroll
      for (int r = 0; r < 16; ++r) { const float rstd = 1.0f / sqrtf(ss[r] * (1.0f / 128.0f) + 1e-6f);
        bf16* op = E.outa + (E.rowbase + U.q0 + qrow_w + crow(r, hi)) * 1024 + E.h * 128 + r32;
#pragma unroll
        for (int d0 = 0; d0 < 4; ++d0) op[d0 * 32] = (bf16)(cvtpk(o[d0][r] * rstd * gcol[d0], 0.f) & 0xffffu); }
    }
    __syncthreads();
  }
#undef ATT_SLOAD
#undef ATT_SWRITE
#undef ATT_SWAIT
#undef ATT_RESC
#undef ATT_MASK
}
}
#define GAS __attribute__((address_space(1)))
#define LAS __attribute__((address_space(3)))
typedef unsigned short bf16;
typedef unsigned v4u __attribute__((ext_vector_type(4)));
typedef float f32x4 __attribute__((ext_vector_type(4)));
typedef short bf16x8 __attribute__((ext_vector_type(8)));
typedef GAS unsigned gu32;
typedef GAS unsigned long long gu64;
#define RLX_AGENT __ATOMIC_RELAXED, __HIP_MEMORY_SCOPE_AGENT
#define LDS_WAIT() asm volatile("s_waitcnt lgkmcnt(0)" ::: "memory")
#define VM_WAIT() asm volatile("s_waitcnt vmcnt(0)" ::: "memory")
__device__ __forceinline__ unsigned long long rt() { return __builtin_amdgcn_s_memrealtime(); }
__device__ __forceinline__ unsigned f2bf(float f) { unsigned u = __builtin_bit_cast(unsigned, f); return (u + 0x7fffu + ((u >> 16) & 1u)) >> 16; }
__device__ __forceinline__ unsigned pk2(float lo, float hi) { return f2bf(lo) | (f2bf(hi) << 16); }
#define XB_TMO      128
#define XB_XCNT(j)  (256  + 64 * (j))
#define XB_XSUB(j)  (1280 + 64 * (j))
#define XB_XGEN(j)  (2304 + 64 * (j))
#define XB_TOP      3328
#define XB_TOPGEN   3392
#define XCD_BAR_WORDS 3456
#define XB_SPIN_CAP (1u << 18)

__device__ __forceinline__ unsigned xb_ld(unsigned* p)              { return __hip_atomic_load(p, __ATOMIC_RELAXED, __HIP_MEMORY_SCOPE_AGENT); }
__device__ __forceinline__ unsigned xb_add(unsigned* p, unsigned v) { return __hip_atomic_fetch_add(p, v, __ATOMIC_RELAXED, __HIP_MEMORY_SCOPE_AGENT); }
__device__ __forceinline__ unsigned xb_xcc_id() { return (unsigned)__builtin_amdgcn_s_getreg((3 << 11) | 20) & 0xFu; }
#define XB_SPIN(cond, bar) do { unsigned _sp = 0; while (cond) { __builtin_amdgcn_s_sleep(1); \
    if ((++_sp & 255u) == 0u) { if (xb_ld(&(bar)[XB_TMO])) break; if (_sp > XB_SPIN_CAP) { atomicAdd(&(bar)[XB_TMO], 1u); break; } } } } while (0)

struct XcdBarrier {
    unsigned* bar; unsigned x;
    volatile LAS unsigned* st;
};

__device__ __forceinline__ XcdBarrier xcd_barrier_post(unsigned* bar, volatile LAS unsigned* st) {
    XcdBarrier b; b.bar = bar; b.x = xb_xcc_id(); b.st = st;
    if (threadIdx.x == 0) (void)xb_add(&bar[XB_XCNT(b.x)], 1u);
    return b;
}
__device__ __forceinline__ void xcd_barrier_complete(unsigned* bar, unsigned x, unsigned& nloc, unsigned& nx) {
    const unsigned G = gridDim.x * gridDim.y * gridDim.z;
    unsigned sum, cnt, mine, sp = 0u;
    for (;;) {
        sum = 0u; cnt = 0u; mine = 0u;
#pragma unroll
        for (unsigned j = 0; j < 16; ++j) { const unsigned c = xb_ld(&bar[XB_XCNT(j)]); sum += c; cnt += (c > 0u) ? 1u : 0u; mine = (j == x) ? c : mine; }
        if (sum == G) break;
        __builtin_amdgcn_s_sleep(1);
        if ((++sp & 255u) == 0u) { if (xb_ld(&bar[XB_TMO])) break; if (sp > XB_SPIN_CAP) { atomicAdd(&bar[XB_TMO], 1u); break; } }
    }
    nloc = mine > 0u ? mine : 1u; nx = cnt > 0u ? cnt : 1u;
}

__device__ __forceinline__ void xcd_barrier(const XcdBarrier& b) {
    asm volatile("s_waitcnt vmcnt(0)" ::: "memory");
    __syncthreads();
    if (threadIdx.x == 0) {
        unsigned* bar = b.bar;
        __builtin_amdgcn_s_waitcnt(0);
        unsigned nloc = b.st[0], nx = b.st[1];
        if (nloc == 0u) { xcd_barrier_complete(bar, b.x, nloc, nx); b.st[0] = nloc; b.st[1] = nx; }
        const unsigned old = xb_add(&bar[XB_XSUB(b.x)], 1u);
        const unsigned gen = old / nloc;
        if (old + 1u == (gen + 1u) * nloc) {
            __builtin_amdgcn_fence(__ATOMIC_RELEASE, "agent");
            asm volatile("s_waitcnt vmcnt(0)" ::: "memory");
            const unsigned og = xb_add(&bar[XB_TOP], 1u);
            const unsigned tg = og / nx;
            if (og + 1u == (tg + 1u) * nx) xb_add(&bar[XB_TOPGEN], 1u);
            else XB_SPIN(xb_ld(&bar[XB_TOPGEN]) == tg, bar);
            __builtin_amdgcn_fence(__ATOMIC_ACQUIRE, "agent");
            xb_add(&bar[XB_XGEN(b.x)], 1u);
            asm volatile("s_waitcnt vmcnt(0)" ::: "memory");
        } else {
            XB_SPIN(xb_ld(&bar[XB_XGEN(b.x)]) == gen, bar);
            __builtin_amdgcn_fence(__ATOMIC_ACQUIRE, "agent");
            asm volatile("s_waitcnt vmcnt(0)" ::: "memory");
        }
    }
    __syncthreads();
}
constexpr int NWAVES = 8;
constexpr int DM = 2048, SEQ = 2048, NSEQ = 12, MROWS = NSEQ * SEQ, MP = 16384, DEPTH = 4;
constexpr int AW = 1024, BOUT = 512, INW = 11776, DFF = 5632;
constexpr int ZC_QA = 0, ZC_KA = 1024, ZC_VA = 2048, ZC_QB = 3072, ZC_KB = 4608, ZC_VB = 6144, ZC_GA = 7680, ZC_GB = 9728;
constexpr float NORM_EPS = 1e-6f;
constexpr size_t MiB = 1u << 20;
constexpr size_t WS_CTL = 0, CTL_ZERO_BYTES = 1 * MiB;
constexpr size_t WS_ROPEA = 1 * MiB, WS_ROPEB = 1 * MiB + 128 * 1024;
constexpr size_t WS_WIN = 2 * MiB, WS_WPA = 186 * MiB, WS_WPB = 202 * MiB, WS_WOUT = 210 * MiB, WS_WFI = 242 * MiB, WS_WFO = 418 * MiB;
constexpr size_t WS_XN = 506 * MiB, WS_MG = 602 * MiB, WS_OUTA = 698 * MiB, WS_OUTB = 746 * MiB, WS_Z = 770 * MiB, WS_END = 1322 * MiB;
constexpr size_t WS_LSE = WS_MG + 80 * MiB;
constexpr size_t LW_IN = (size_t)INW * DM * 2, LW_PA = (size_t)DM * AW * 2, LW_PB = (size_t)DM * BOUT * 2, LW_OUT = (size_t)DM * DM * 2, LW_FI = (size_t)2 * DFF * DM * 2, LW_FO = (size_t)DM * DFF * 2;
static_assert(WS_WIN + 4 * LW_IN == WS_WPA && WS_WPA + 4 * LW_PA == WS_WPB && WS_WPB + 4 * LW_PB == WS_WOUT && WS_WOUT + 4 * LW_OUT == WS_WFI && WS_WFI + 4 * LW_FI == WS_WFO && WS_WFO + 4 * LW_FO == WS_XN, "weight map");
static_assert(WS_XN + (size_t)MROWS * DM * 2 == WS_MG && WS_MG + (size_t)MROWS * DM * 2 == WS_OUTA && WS_OUTA + (size_t)MROWS * AW * 2 == WS_OUTB && WS_OUTB + (size_t)MROWS * BOUT * 2 == WS_Z && WS_Z + (size_t)MROWS * INW * 2 == WS_END, "activation map");
static_assert((size_t)3 * MROWS * BOUT * 2 <= 80 * MiB && WS_LSE + (size_t)3 * MROWS * 4 * 4 <= WS_OUTA, "dilated partials fit the MG region");
constexpr int CW_TMO = 0, CW_CODE = 1, CW_BAR = 4096;
constexpr int RING_OFF = 0, RING_BYTES = 131072, LDSCTL_OFF = RING_BYTES, MISC_OFF = LDSCTL_OFF + 320, LDS_BYTES = 147456;
constexpr int PH_PER_LAYER = 10, PH_FINAL = 1 + PH_PER_LAYER * DEPTH, PH_END = PH_FINAL + 1;

struct Frame {
    LAS unsigned char* lds; volatile LAS unsigned* MISC; gu32* ctl;
    int tid, lane, wave, vcu, G;
};
__device__ __forceinline__ float wave_sum(float v) {
#pragma unroll
    for (int o = 1; o < 64; o <<= 1) v += __shfl_xor(v, o);
    return v;
}
__device__ __forceinline__ void transpose_item(const float* W, int K, int N, bf16* WT, LAS float* scr, int k0, int n0, int drow0, int lane) {
#pragma unroll 8
    for (int i = 0; i < 32; ++i) { const int kk = 2 * i + (lane >> 5); scr[kk * 33 + (lane & 31)] = W[(size_t)(k0 + kk) * N + n0 + (lane & 31)]; }
    LDS_WAIT(); asm volatile("" ::: "memory");
    const int c = lane & 7;
#pragma unroll
    for (int j = 0; j < 4; ++j) { const int n = (lane >> 3) + 8 * j; const LAS float* s = scr + (8 * c) * 33 + n;
        v4u o; o.x = pk2(s[0 * 33], s[1 * 33]); o.y = pk2(s[2 * 33], s[3 * 33]); o.z = pk2(s[4 * 33], s[5 * 33]); o.w = pk2(s[6 * 33], s[7 * 33]);
        *(GAS v4u*)(WT + (size_t)(drow0 + n) * K + k0 + 8 * c) = o; }
    LDS_WAIT(); asm volatile("" ::: "memory");
}
struct Ins { const float *xp, *xs, *norm_mix, *norm_ffn, *w_in, *gate_bias, *diff_lambda, *diff_subln, *w_pa, *w_pb, *w_out, *w_fi, *w_fo, *norm_final; };
__device__ __forceinline__ void p0_prologue(Frame& F, const Ins& I, unsigned char* ws) {
    LAS float* scr = (LAS float*)(F.lds + RING_OFF + F.wave * 16384);
    const int gw = F.vcu * NWAVES + F.wave, NGW = F.G * NWAVES;
    constexpr int I_IN = (DM / 64) * (INW / 32), I_PA = (AW / 64) * (DM / 32), I_PB = (BOUT / 64) * (DM / 32), I_OUT = (DM / 64) * (DM / 32), I_FI = (DM / 64) * (2 * DFF / 32), I_FO = (DFF / 64) * (DM / 32);
    constexpr int LAYER_ITEMS = I_IN + I_PA + I_PB + I_OUT + I_FI + I_FO;
    for (int it = gw; it < DEPTH * LAYER_ITEMS; it += NGW) {
        const int l = it / LAYER_ITEMS; int r = it % LAYER_ITEMS;
        if (r < I_IN) { const int nblk = INW / 32, kb = r / nblk, nb = r % nblk; transpose_item(I.w_in + (size_t)l * DM * INW, DM, INW, (bf16*)(ws + WS_WIN + l * LW_IN), scr, 64 * kb, 32 * nb, 32 * nb, F.lane); continue; } r -= I_IN;
        if (r < I_PA) { const int nblk = DM / 32, kb = r / nblk, nb = r % nblk; transpose_item(I.w_pa + (size_t)l * AW * DM, AW, DM, (bf16*)(ws + WS_WPA + l * LW_PA), scr, 64 * kb, 32 * nb, 32 * nb, F.lane); continue; } r -= I_PA;
        if (r < I_PB) { const int nblk = DM / 32, kb = r / nblk, nb = r % nblk; transpose_item(I.w_pb + (size_t)l * BOUT * DM, BOUT, DM, (bf16*)(ws + WS_WPB + l * LW_PB), scr, 64 * kb, 32 * nb, 32 * nb, F.lane); continue; } r -= I_PB;
        if (r < I_OUT) { const int nblk = DM / 32, kb = r / nblk, nb = r % nblk; transpose_item(I.w_out + (size_t)l * DM * DM, DM, DM, (bf16*)(ws + WS_WOUT + l * LW_OUT), scr, 64 * kb, 32 * nb, 32 * nb, F.lane); continue; } r -= I_OUT;
        if (r < I_FI) { const int nblk = 2 * DFF / 32, kb = r / nblk, nb = r % nblk, n0 = 32 * nb;
            const int drow = (n0 < DFF) ? 256 * (n0 / 128) + (n0 % 128) : 256 * ((n0 - DFF) / 128) + 128 + ((n0 - DFF) % 128);
            transpose_item(I.w_fi + (size_t)l * DM * 2 * DFF, DM, 2 * DFF, (bf16*)(ws + WS_WFI + l * LW_FI), scr, 64 * kb, n0, drow, F.lane); continue; } r -= I_FI;
        { const int nblk = DM / 32, kb = r / nblk, nb = r % nblk; transpose_item(I.w_fo + (size_t)l * DFF * DM, DFF, DM, (bf16*)(ws + WS_WFO + l * LW_FO), scr, 64 * kb, 32 * nb, 32 * nb, F.lane); }
    }
    float* ropeA = (float*)(ws + WS_ROPEA); float* ropeB = (float*)(ws + WS_ROPEB);
    const int gt = F.vcu * (NWAVES * 64) + F.tid, NGT = F.G * NWAVES * 64;
    for (int e = gt; e < SEQ * 8 + SEQ * 16; e += NGT) {
        const bool isA = e < SEQ * 8; const int ee = isA ? e : e - SEQ * 8; const int half = isA ? 8 : 16; const int pos = ee / half, i = ee % half;
        const float inv = (float)pow(500000.0, -(double)(2 * i) / (double)(2 * half));
        const float ang = (float)pos * inv;
        const double a = (double)ang; const float c = (float)cos(a), s = (float)sin(a);
        float* t = isA ? ropeA + pos * 16 : ropeB + pos * 32; t[i] = c; t[half + i] = s;
    }
}
__device__ __forceinline__ void norm_rows_bf16(Frame& F, const float* lo, const float* hi, const float* g, bf16* dst) {
    const int gw = F.vcu * NWAVES + F.wave, NGW = F.G * NWAVES;
    f32x4 gv[8];
#pragma unroll
    for (int j = 0; j < 8; ++j) gv[j] = ((const f32x4*)g)[F.lane + 64 * j];
    for (int row = gw; row < MROWS; row += NGW) {
        const float* xr = (row < MP) ? lo + (size_t)row * DM : hi + (size_t)(row - MP) * DM;
        f32x4 v[8]; float s = 0.f;
#pragma unroll
        for (int j = 0; j < 8; ++j) { v[j] = ((const GAS f32x4*)xr)[F.lane + 64 * j]; s += (v[j].x * v[j].x + v[j].y * v[j].y) + (v[j].z * v[j].z + v[j].w * v[j].w); }
        const float rstd = 1.0f / sqrtf(wave_sum(s) * (1.0f / DM) + NORM_EPS);
        GAS unsigned long long* o8 = (GAS unsigned long long*)(dst + (size_t)row * DM) + F.lane;
#pragma unroll
        for (int j = 0; j < 8; ++j) { const f32x4 y = v[j] * rstd * gv[j]; o8[64 * j] = (unsigned long long)pk2(y.x, y.y) | ((unsigned long long)pk2(y.z, y.w) << 32); }
    }
}
__device__ __forceinline__ void norm_rows_f32_inplace(Frame& F, float* x, const float* g) {
    const int gw = F.vcu * NWAVES + F.wave, NGW = F.G * NWAVES;
    f32x4 gv[8];
#pragma unroll
    for (int j = 0; j < 8; ++j) gv[j] = ((const f32x4*)g)[F.lane + 64 * j];
    for (int row = gw; row < MROWS; row += NGW) {
        GAS f32x4* xr = (GAS f32x4*)(x + (size_t)row * DM);
        f32x4 v[8]; float s = 0.f;
#pragma unroll
        for (int j = 0; j < 8; ++j) { v[j] = xr[F.lane + 64 * j]; s += (v[j].x * v[j].x + v[j].y * v[j].y) + (v[j].z * v[j].z + v[j].w * v[j].w); }
        const float rstd = 1.0f / sqrtf(wave_sum(s) * (1.0f / DM) + NORM_EPS);
#pragma unroll
        for (int j = 0; j < 8; ++j) xr[F.lane + 64 * j] = v[j] * rstd * gv[j];
    }
}
__device__ __forceinline__ float lam_init_of(int l) { return 0.8f - 0.6f * expf(-0.3f * (float)l); }
__device__ __forceinline__ void combine_phase(Frame& F, const bf16* obpart, const float* lse, bf16* outb) {
    const int gw = F.vcu * NWAVES + F.wave, NGW = F.G * NWAVES, lane = F.lane;
    const int hB = lane >> 4, eB = (lane & 15) * 8;
    for (int tok = gw; tok < MROWS; tok += NGW) {
        const float l0 = lse[(size_t)(0 * MROWS + tok) * 4 + hB], l1 = lse[(size_t)(1 * MROWS + tok) * 4 + hB], l2 = lse[(size_t)(2 * MROWS + tok) * 4 + hB];
        const float mx = fmaxf(l0, fmaxf(l1, l2)); float w_0 = expf(l0 - mx), w_1 = expf(l1 - mx), w_2 = expf(l2 - mx); const float wi = 1.0f / (w_0 + w_1 + w_2); w_0 *= wi; w_1 *= wi; w_2 *= wi;
        const v4u p0 = *(const GAS v4u*)(obpart + ((size_t)(0 * MROWS + tok)) * BOUT + hB * 128 + eB), p1 = *(const GAS v4u*)(obpart + ((size_t)(1 * MROWS + tok)) * BOUT + hB * 128 + eB), p2 = *(const GAS v4u*)(obpart + ((size_t)(2 * MROWS + tok)) * BOUT + hB * 128 + eB);
        v4u wb;
#pragma unroll
        for (int j = 0; j < 4; ++j) wb[j] = pk2(w_0 * pg8::bflo(p0[j]) + w_1 * pg8::bflo(p1[j]) + w_2 * pg8::bflo(p2[j]), w_0 * pg8::bfhi(p0[j]) + w_1 * pg8::bfhi(p1[j]) + w_2 * pg8::bfhi(p2[j]));
        *(GAS v4u*)(outb + (size_t)tok * BOUT + hB * 128 + eB) = wb;
    }
}
constexpr int N_DIFF_UNITS = NSEQ * 8 * (SEQ / 128), N_DIL_UNITS = NSEQ * 3 * 4 * (SEQ / 256);
__device__ __forceinline__ void attention_phase(char* lds, const bf16* Z, bf16* outa, bf16* obpart, float* lse, const float* dlam, const float* subln, int l, int vcu, int G) {
    const int lane = threadIdx.x & 63;
    const float li = lam_init_of(l);
    const float e1 = expf(wave_sum(dlam[lane] * dlam[64 + lane])), e2 = expf(wave_sum(dlam[128 + lane] * dlam[192 + lane]));
    const float lam = e1 - e2 + li;
    const int u0 = (int)((long)vcu * N_DIFF_UNITS / G), u1 = (int)((long)(vcu + 1) * N_DIFF_UNITS / G);
    for (int u = u0; u < u1; ++u) {
        const int qb = u & 15, h = (u >> 4) & 7, b = u >> 7;
        att::UnitP U; U.Zb = Z + (size_t)b * SEQ * INW; U.qcol = ZC_QA + h * 128; U.kcol = ZC_KA + h * 128; U.vcol = ZC_VA + h * 128; U.q0 = qb * 128; U.ts = 0; U.nt = SEQ / 64; U.ldil = 0; U.lnsub = 11;
        const att::EpiDiff E{outa, subln, lam, 1.0f - li, h, (long)b * SEQ};
        att::attn_unit<false, att::EpiDiff>(U, E, lds);
    }
    const int d0 = (int)((long)vcu * N_DIL_UNITS / G), d1 = (int)((long)(vcu + 1) * N_DIL_UNITS / G);
    for (int u = d0; u < d1; ++u) {
        const int qb = u & 7, hh = (u >> 3) & 3, g = (u >> 5) % 3, b = u / 96, head = g * 4 + hh;
        att::UnitP U; U.Zb = Z + (size_t)b * SEQ * INW; U.qcol = ZC_QB + head * 128; U.kcol = ZC_KB + head * 128; U.vcol = ZC_VB + head * 128; U.q0 = qb * 256;
        int ts = qb * 4 - 1; ts = ts < 0 ? 0 : (ts > SEQ / 64 - 6 ? SEQ / 64 - 6 : ts); U.ts = ts; U.nt = 6; U.ldil = 2 * g; U.lnsub = 11 - 2 * g;
        const att::EpiDil E{obpart + (size_t)g * MROWS * BOUT, lse + (size_t)g * MROWS * 4, hh, (long)b * SEQ};
        att::attn_unit<true, att::EpiDil>(U, E, lds);
    }
}

struct Args { const float* in[14]; float* out; unsigned char* ws; int ph_lo, ph_hi, li, pad; };
typedef const __attribute__((address_space(4))) Args* KArgP;
#define KARG() ({ KArgP p_ = (KArgP)__builtin_amdgcn_kernarg_segment_ptr(); asm volatile("" : "+s"(p_)); p_; })
__device__ __forceinline__ Frame mkframe(LAS unsigned char* lds, unsigned char* ws) {
    Frame F; F.lds = lds; F.MISC = (volatile LAS unsigned*)(lds + MISC_OFF); F.ctl = (gu32*)(ws + WS_CTL);
    int tid = threadIdx.x; asm volatile("" : "+v"(tid));
    int G = gridDim.x, bx = blockIdx.x; asm volatile("" : "+s"(G), "+s"(bx));
    F.tid = tid; F.lane = tid & 63; F.wave = __builtin_amdgcn_readfirstlane(tid >> 6); F.G = G; F.vcu = (G % 8 == 0) ? (bx % 8) * (G / 8) + bx / 8 : bx;
    return F;
}
__global__ void __launch_bounds__(NWAVES * 64, 2) fwd(Args args) {
    extern __shared__ __attribute__((aligned(16))) unsigned char lds[];
    LAS unsigned char* const L = (LAS unsigned char*)lds;
    for (int u = threadIdx.x; u < (LDS_BYTES - LDSCTL_OFF) / 4; u += NWAVES * 64) ((LAS unsigned*)(L + LDSCTL_OFF))[u] = 0u;
    __syncthreads();
    XcdBarrier bar = xcd_barrier_post((unsigned*)(args.ws + WS_CTL) + CW_BAR + args.li * XCD_BAR_WORDS, (volatile LAS unsigned*)(L + MISC_OFF) + 8);
    const int lo = args.ph_lo, hi = args.ph_hi;
#define IN(k) (lo <= (k) && (k) < hi)
#define SEAM(k) do { if (IN((k) + 1)) xcd_barrier(bar); } while (0)
#define BX() ({ int b_ = blockIdx.x; asm volatile("" : "+s"(b_)); b_; })

    if (IN(0)) { KArgP A = KARG(); unsigned char* ws = A->ws; Frame F = mkframe(L, ws);
        Ins I; I.xp = A->in[0]; I.xs = A->in[1]; I.norm_mix = A->in[2]; I.norm_ffn = A->in[3]; I.w_in = A->in[4]; I.gate_bias = A->in[5]; I.diff_lambda = A->in[6]; I.diff_subln = A->in[7];
        I.w_pa = A->in[8]; I.w_pb = A->in[9]; I.w_out = A->in[10]; I.w_fi = A->in[11]; I.w_fo = A->in[12]; I.norm_final = A->in[13];
        p0_prologue(F, I, ws); SEAM(0); }
    for (int l = 0; l < DEPTH; ++l) {
        const int pb = 1 + PH_PER_LAYER * l;
        if (IN(pb + 0)) { KArgP A = KARG(); unsigned char* ws = A->ws; Frame F = mkframe(L, ws); float* xout = A->out;
            const float* xlo = (l == 0) ? A->in[0] : xout; const float* xhi = (l == 0) ? A->in[1] : xout + (size_t)MP * DM;
            norm_rows_bf16(F, xlo, xhi, A->in[2] + l * DM, (bf16*)(ws + WS_XN)); SEAM(pb + 0); }
        if (IN(pb + 1)) { KArgP A = KARG(); unsigned char* ws = A->ws;
            pg8::Gemm g{(const bf16*)(ws + WS_XN), (const bf16*)(ws + WS_WIN + l * LW_IN), MROWS, INW, DM}; pg8::StaticOrder S; S.init(MROWS, INW, gridDim.x, BX());
            pg8::EpiIn E{(bf16*)(ws + WS_Z), (const float*)(ws + WS_ROPEA), (const float*)(ws + WS_ROPEB), A->in[5] + l * 2 * DM};
            pg8::gemm_phase<pg8::EpiIn, pg8::StaticOrder, true, true>(L + RING_OFF, g, S, E);
            SEAM(pb + 1);
        }
        if (IN(pb + 2)) { KArgP A = KARG(); unsigned char* ws = A->ws; Frame F = mkframe(L, ws);
            attention_phase((char*)lds, (const bf16*)(ws + WS_Z), (bf16*)(ws + WS_OUTA), (bf16*)(ws + WS_MG), (float*)(ws + WS_LSE), A->in[6] + l * 256, A->in[7] + l * 128, l, F.vcu, F.G);
            SEAM(pb + 2); }
        if (IN(pb + 3)) { KArgP A = KARG(); unsigned char* ws = A->ws; Frame F = mkframe(L, ws);
            combine_phase(F, (const bf16*)(ws + WS_MG), (const float*)(ws + WS_LSE), (bf16*)(ws + WS_OUTB)); SEAM(pb + 3); }
        if (IN(pb + 4)) { KArgP A = KARG(); unsigned char* ws = A->ws;
            pg8::Gemm g{(const bf16*)(ws + WS_OUTA), (const bf16*)(ws + WS_WPA + l * LW_PA), MROWS, DM, AW}; pg8::StaticOrder S; S.init(MROWS, DM, gridDim.x, BX());
            pg8::EpiGate<0> E{(bf16*)(ws + WS_MG), (const bf16*)(ws + WS_Z), ZC_GA};
            pg8::gemm_phase<pg8::EpiGate<0>, pg8::StaticOrder, true, true>(L + RING_OFF, g, S, E);
        }
        if (IN(pb + 5)) { KArgP A = KARG(); unsigned char* ws = A->ws;
            pg8::Gemm g{(const bf16*)(ws + WS_OUTB), (const bf16*)(ws + WS_WPB + l * LW_PB), MROWS, DM, BOUT}; pg8::StaticOrder S; S.init(MROWS, DM, gridDim.x, BX());
            pg8::EpiGate<1> E{(bf16*)(ws + WS_MG), (const bf16*)(ws + WS_Z), ZC_GB};
            pg8::gemm_phase<pg8::EpiGate<1>, pg8::StaticOrder, true, true>(L + RING_OFF, g, S, E);
            SEAM(pb + 5);
        }
        if (IN(pb + 6)) { KArgP A = KARG(); unsigned char* ws = A->ws; float* xout = A->out;
            const float* xlo = (l == 0) ? A->in[0] : xout; const float* xhi = (l == 0) ? A->in[1] : xout + (size_t)MP * DM;
            pg8::Gemm g{(const bf16*)(ws + WS_MG), (const bf16*)(ws + WS_WOUT + l * LW_OUT), MROWS, DM, DM}; pg8::StaticOrder S; S.init(MROWS, DM, gridDim.x, BX());
            pg8::EpiResid E{xlo, xhi, xout};
            pg8::gemm_phase<pg8::EpiResid, pg8::StaticOrder, true, true>(L + RING_OFF, g, S, E);
            SEAM(pb + 6);
        }
        if (IN(pb + 7)) { KArgP A = KARG(); unsigned char* ws = A->ws; Frame F = mkframe(L, ws); float* xout = A->out;
            norm_rows_bf16(F, xout, xout + (size_t)MP * DM, A->in[3] + l * DM, (bf16*)(ws + WS_XN)); SEAM(pb + 7); }
        if (IN(pb + 8)) { KArgP A = KARG(); unsigned char* ws = A->ws;
            pg8::Gemm g{(const bf16*)(ws + WS_XN), (const bf16*)(ws + WS_WFI + l * LW_FI), MROWS, 2 * DFF, DM}; pg8::StaticOrder S; S.init(MROWS, 2 * DFF, gridDim.x, BX());
            pg8::EpiSwiglu E{(bf16*)(ws + WS_Z)};
            pg8::gemm_phase<pg8::EpiSwiglu, pg8::StaticOrder, true, true>(L + RING_OFF, g, S, E);
            SEAM(pb + 8);
        }
        if (IN(pb + 9)) { KArgP A = KARG(); unsigned char* ws = A->ws; float* xout = A->out;
            pg8::Gemm g{(const bf16*)(ws + WS_Z), (const bf16*)(ws + WS_WFO + l * LW_FO), MROWS, DM, DFF}; pg8::StaticOrder S; S.init(MROWS, DM, gridDim.x, BX());
            pg8::EpiResid E{xout, xout + (size_t)MP * DM, xout};
            pg8::gemm_phase<pg8::EpiResid, pg8::StaticOrder, true, true>(L + RING_OFF, g, S, E);
            SEAM(pb + 9);
        }
    }
    if (IN(PH_FINAL)) { KArgP A = KARG(); Frame F = mkframe(L, A->ws); norm_rows_f32_inplace(F, A->out, A->in[13]); }
#undef IN
#undef SEAM
#undef BX
}

extern "C" void kernel_launch(void* const* d_in, const int* in_sizes, int n_in, void* d_out, int out_size, void* d_ws, size_t ws_size, hipStream_t stream) {
    static int grid = 0;
    if (grid == 0) {
        if (n_in != 14 || out_size != MROWS * DM || ws_size < WS_END) { fprintf(stderr, "kernel_launch: unexpected shapes: n_in %d out %d ws %zu (need %zu)\n", n_in, out_size, ws_size, (size_t)WS_END); grid = -1; return; }
        int dev = 0, cus = 0, per_cu = 0;
        if (hipGetDevice(&dev) != hipSuccess || hipDeviceGetAttribute(&cus, hipDeviceAttributeMultiprocessorCount, dev) != hipSuccess) { grid = -1; return; }
        if (hipFuncSetAttribute((const void*)fwd, hipFuncAttributeMaxDynamicSharedMemorySize, LDS_BYTES) != hipSuccess) { fprintf(stderr, "kernel_launch: hipFuncSetAttribute failed\n"); grid = -1; return; }
        if (hipOccupancyMaxActiveBlocksPerMultiprocessor(&per_cu, (const void*)fwd, NWAVES * 64, LDS_BYTES) != hipSuccess || per_cu < 1) fprintf(stderr, "kernel_launch: occupancy query reports %d\n", per_cu);
        (void)hipGetLastError();
        grid = cus;
    }
    if (grid < 0) return;
    (void)hipMemsetAsync((char*)d_ws + WS_CTL, 0, CTL_ZERO_BYTES, stream);
    Args a{};
    for (int i = 0; i < 14; ++i) a.in[i] = (const float*)d_in[i];
    a.out = (float*)d_out; a.ws = (unsigned char*)d_ws;
    a.ph_lo = 0; a.ph_hi = PH_END; a.li = 0;
    hipLaunchKernelGGL(fwd, dim3(grid), dim3(NWAVES * 64), LDS_BYTES, stream, a);
    const hipError_t le = hipPeekAtLastError();
    if (le != hipSuccess) fprintf(stderr, "kernel_launch: launch failed: %s\n", hipGetErrorName(le));
}
```
